# Optimizing an MI355X kernel written in HIP

```python
import jax, jax.numpy as jnp
from jax import lax
import numpy as np

D_MODEL = 2048
BATCH = 4
SEQ = 2048
DEPTH = 2

CHUNK = 64
N_MIXERS = 2
EPS = 1e-6

GLA_HEADS = 4
GLA_DK = D_MODEL // 2
GLA_DV = D_MODEL
GLA_DK_HEAD = GLA_DK // GLA_HEADS
GLA_DV_HEAD = GLA_DV // GLA_HEADS
GLA_GATE_RANK = 16
GLA_TAU = 16.0
GLA_IN = 2 * GLA_DK + 2 * GLA_DV + GLA_GATE_RANK

SGU_WIDTH = D_MODEL
SGU_BLOCK = 128
SGU_GROUPS = 8
SGU_GROUP_DIM = SGU_WIDTH // SGU_GROUPS
SGU_IN = 3 * SGU_WIDTH

N_GLA_LAYERS = (DEPTH + 1) // 2
N_SGU_LAYERS = DEPTH // 2

kernel_name = "hybrid_gla_sgu_sandwich_trunk"


def rmsnorm(x, gain):
    xf = x.astype(jnp.float32)
    y = xf * lax.rsqrt(jnp.mean(xf * xf, axis=-1, keepdims=True) + EPS)
    return (y * gain.astype(jnp.float32)).astype(x.dtype)


def gla_mixer(h, w_in, w_gate2, b_gate, o_gain, w_out):
    B, S, _ = h.shape
    nc = S // CHUNK
    proj = h @ w_in
    q, k, v, g, glr = jnp.split(
        proj, [GLA_DK, 2 * GLA_DK, 2 * GLA_DK + GLA_DV, 2 * GLA_DK + 2 * GLA_DV], axis=-1)
    log_a = jax.nn.log_sigmoid((glr @ w_gate2 + b_gate).astype(jnp.float32)) / GLA_TAU

    def to_chunks(t, dh):
        return t.astype(jnp.float32).reshape(B, nc, CHUNK, GLA_HEADS, dh).transpose(1, 0, 3, 2, 4)

    qc = to_chunks(q, GLA_DK_HEAD) * (GLA_DK_HEAD ** -0.5)
    kc = to_chunks(k, GLA_DK_HEAD)
    vc = to_chunks(v, GLA_DV_HEAD)
    la = to_chunks(log_a, GLA_DK_HEAD)
    bcum = jnp.cumsum(la, axis=3)
    b_end = bcum[:, :, :, -1:, :]
    k_dec = kc * jnp.exp(b_end - bcum)
    decay = jnp.exp(b_end[:, :, :, 0, :])

    def step(state, xs):
        q_i, k_i, v_i, d_i = xs
        state = state * d_i[..., None] + jnp.einsum('bhck,bhcv->bhkv', k_i, v_i)
        return state, jnp.einsum('bhck,bhkv->bhcv', q_i, state)

    s0 = jnp.zeros((B, GLA_HEADS, GLA_DK_HEAD, GLA_DV_HEAD), jnp.float32)
    _, o = lax.scan(step, s0, (qc, k_dec, vc, decay))
    o = o.transpose(1, 0, 3, 2, 4).reshape(B, S, GLA_HEADS, GLA_DV_HEAD)
    o = o * lax.rsqrt(jnp.mean(o * o, axis=-1, keepdims=True) + EPS)
    o = o.reshape(B, S, GLA_DV) * o_gain.astype(jnp.float32)
    o = o.astype(h.dtype) * jax.nn.silu(g)
    return o @ w_out


def sgu_mixer(h, w_in, ln_gain, ln_bias, w_spatial, b_spatial, w_out):
    B, S, _ = h.shape
    nb = S // SGU_BLOCK
    proj = h @ w_in
    u, v, g = jnp.split(proj, 3, axis=-1)
    u = jax.nn.gelu(u)
    vf = jax.nn.gelu(v).astype(jnp.float32)
    mu = jnp.mean(vf, axis=-1, keepdims=True)
    var = jnp.mean(jnp.square(vf - mu), axis=-1, keepdims=True)
    vn = (vf - mu) * lax.rsqrt(var + EPS) * ln_gain.astype(jnp.float32) + ln_bias.astype(jnp.float32)
    vn = vn.reshape(B, nb, SGU_BLOCK, SGU_GROUPS, SGU_GROUP_DIM)
    pos_chunk = jnp.arange(SGU_BLOCK) // CHUNK
    mask = pos_chunk[:, None] >= pos_chunk[None, :]
    ws = jnp.where(mask[None], w_spatial, 0).astype(jnp.float32)
    vs = jnp.einsum('gij,bnjgd->bnigd', ws, vn) \
        + b_spatial.astype(jnp.float32).T[None, None, :, :, None]
    vs = vs.reshape(B, S, SGU_WIDTH).astype(h.dtype)
    return (u * vs * jax.nn.silu(g)) @ w_out


def setup_inputs(seed: int = 0) -> dict:
    key = jax.random.key(seed)
    ks = jax.random.split(key, 15)
    f32 = jnp.float32
    nrm = lambda k, shape, scale: jax.random.normal(k, shape, f32) * scale
    return {
        "x": nrm(ks[0], (BATCH, SEQ, D_MODEL), 1.0),
        "norm_pre": 1.0 + nrm(ks[1], (DEPTH, D_MODEL), 0.02),
        "norm_post": 1.0 + nrm(ks[2], (DEPTH, D_MODEL), 0.02),
        "gla_w_in": nrm(ks[3], (N_GLA_LAYERS, D_MODEL, GLA_IN), D_MODEL ** -0.5),
        "gla_w_gate2": nrm(ks[4], (N_GLA_LAYERS, GLA_GATE_RANK, GLA_DK), GLA_GATE_RANK ** -0.5),
        "gla_b_gate": nrm(ks[5], (N_GLA_LAYERS, GLA_DK), 0.1),
        "gla_o_gain": 1.0 + nrm(ks[6], (N_GLA_LAYERS, GLA_DV), 0.02),
        "gla_w_out": nrm(ks[7], (N_GLA_LAYERS, GLA_DV, D_MODEL), GLA_DV ** -0.5),
        "sgu_w_in": nrm(ks[8], (N_SGU_LAYERS, D_MODEL, SGU_IN), D_MODEL ** -0.5),
        "sgu_ln_gain": 1.0 + nrm(ks[9], (N_SGU_LAYERS, SGU_WIDTH), 0.02),
        "sgu_ln_bias": nrm(ks[10], (N_SGU_LAYERS, SGU_WIDTH), 0.02),
        "sgu_w_spatial": nrm(ks[11], (N_SGU_LAYERS, SGU_GROUPS, SGU_BLOCK, SGU_BLOCK), SGU_BLOCK ** -0.5),
        "sgu_b_spatial": 1.0 + nrm(ks[12], (N_SGU_LAYERS, SGU_GROUPS, SGU_BLOCK), 0.1),
        "sgu_w_out": nrm(ks[13], (N_SGU_LAYERS, SGU_WIDTH, D_MODEL), SGU_WIDTH ** -0.5),
    }


def reference(x, norm_pre, norm_post, gla_w_in, gla_w_gate2, gla_b_gate, gla_o_gain,
              gla_w_out, sgu_w_in, sgu_ln_gain, sgu_ln_bias, sgu_w_spatial, sgu_b_spatial,
              sgu_w_out):
    for i in range(DEPTH):
        h = rmsnorm(x, norm_pre[i])
        j = i // N_MIXERS
        if i % N_MIXERS == 0:
            y = gla_mixer(h, gla_w_in[j], gla_w_gate2[j], gla_b_gate[j], gla_o_gain[j], gla_w_out[j])
        else:
            y = sgu_mixer(h, sgu_w_in[j], sgu_ln_gain[j], sgu_ln_bias[j], sgu_w_spatial[j],
                          sgu_b_spatial[j], sgu_w_out[j])
        x = x + rmsnorm(y, norm_post[i])
    return x
```

```cpp
#include <hip/hip_runtime.h>
#include <cstdio>
#include <cstdint>

constexpr int DM = 2048, NB = 4, SEQ = 2048, MT = NB * SEQ;
constexpr int CHUNK = 64, NCH = SEQ / CHUNK;
constexpr int GH = 4, GDK = 1024, GDV = 2048, DKH = 256, DVH = 512, GRANK = 16, GLA_IN = 6160, GLA_N = 6144;
constexpr int SGW = 2048, SBLK = 128, SGG = 8, SGD = 256, SGU_IN = 6144;
constexpr float EPS = 1e-6f;
constexpr int NWAVES = 8, NTHR = 512;

constexpr size_t MiB = 1u << 20;
constexpr size_t WS_CTL = 0, CTL_ZERO_BYTES = 1 * MiB;
constexpr size_t WS_WT1 = 2 * MiB;
constexpr size_t WS_WT2 = 26 * MiB;
constexpr size_t WS_WT3 = 34 * MiB;
constexpr size_t WS_WT4 = 58 * MiB;
constexpr size_t WS_WSP = 66 * MiB;
constexpr size_t WS_GLR = 67 * MiB;
constexpr size_t WS_DEC = 67 * MiB + 512 * 1024;
constexpr size_t WS_STAT = 68 * MiB;
constexpr size_t WS_XCH = 70 * MiB;
constexpr size_t WS_HA = 72 * MiB;
constexpr size_t WS_H1 = 104 * MiB;
constexpr size_t WS_PROJ = 136 * MiB;
constexpr size_t WS_END = 232 * MiB;
constexpr int CW_TMO = 0, CW_CODE = 1, CW_BAR = 4096;

constexpr int RING_BYTES = 131072, LDS_BYTES = 147456, LDSCTL_OFF = LDS_BYTES - 512, MISC_OFF = LDSCTL_OFF;

#define GAS __attribute__((address_space(1)))
#define LAS __attribute__((address_space(3)))
typedef unsigned short bf16;
typedef unsigned v4u __attribute__((ext_vector_type(4)));
typedef unsigned v2u __attribute__((ext_vector_type(2)));
typedef float f32x4 __attribute__((ext_vector_type(4)));
typedef GAS unsigned gu32;
#define RLX_AGENT __ATOMIC_RELAXED, __HIP_MEMORY_SCOPE_AGENT
#define LDS_WAIT() asm volatile("s_waitcnt lgkmcnt(0)" ::: "memory")
#define VM_WAIT() asm volatile("s_waitcnt vmcnt(0)" ::: "memory")
__device__ __forceinline__ unsigned f2bf(float f) { unsigned u = __builtin_bit_cast(unsigned, f); return (u + 0x7fffu + ((u >> 16) & 1u)) >> 16; }
__device__ __forceinline__ unsigned pk2(float lo, float hi) { return f2bf(lo) | (f2bf(hi) << 16); }
__device__ __forceinline__ float bflo(unsigned w) { return __builtin_bit_cast(float, w << 16); }
__device__ __forceinline__ float bfhi(unsigned w) { return __builtin_bit_cast(float, w & 0xffff0000u); }
__device__ __forceinline__ float bf2f(bf16 h) { return __builtin_bit_cast(float, (unsigned)h << 16); }
__device__ __forceinline__ float silu_f(float x) { return x / (1.f + __expf(-x)); }
__device__ __forceinline__ float gelu_tanh_f(float x) { const float u = 0.7978845608028654f * (x + 0.044715f * x * x * x); return x / (1.f + __expf(-2.f * u)); }
__device__ __forceinline__ float wave_sum(float v) {
#pragma unroll
    for (int o = 1; o < 64; o <<= 1) v += __shfl_xor(v, o);
    return v;
}

#define XB_TMO      128
#define XB_XCNT(j)  (256  + 64 * (j))
#define XB_XSUB(j)  (1280 + 64 * (j))
#define XB_XGEN(j)  (2304 + 64 * (j))
#define XB_TOP      3328
#define XB_TOPGEN   3392
#define XCD_BAR_WORDS 3456
#define XB_SPIN_CAP (1u << 22)
__device__ __forceinline__ unsigned xb_ld(unsigned* p)              { return __hip_atomic_load(p, __ATOMIC_RELAXED, __HIP_MEMORY_SCOPE_AGENT); }
__device__ __forceinline__ unsigned xb_add(unsigned* p, unsigned v) { return __hip_atomic_fetch_add(p, v, __ATOMIC_RELAXED, __HIP_MEMORY_SCOPE_AGENT); }
__device__ __forceinline__ unsigned xb_xcc_id() { return (unsigned)__builtin_amdgcn_s_getreg((3 << 11) | 20) & 0xFu; }
#define XB_SPIN(cond, bar) do { unsigned _sp = 0; while (cond) { __builtin_amdgcn_s_sleep(1); \
    if ((++_sp & 255u) == 0u) { if (xb_ld(&(bar)[XB_TMO])) break; if (_sp > XB_SPIN_CAP) { atomicAdd(&(bar)[XB_TMO], 1u); break; } } } } while (0)
struct XcdBarrier { unsigned* bar; unsigned x; volatile LAS unsigned* st; };
__device__ __forceinline__ XcdBarrier xcd_barrier_post(unsigned* bar, volatile LAS unsigned* st) {
    XcdBarrier b; b.bar = bar; b.x = xb_xcc_id(); b.st = st;
    if (threadIdx.x == 0) (void)xb_add(&bar[XB_XCNT(b.x)], 1u);
    return b;
}
__device__ __forceinline__ void xcd_barrier_complete(unsigned* bar, unsigned x, unsigned& nloc, unsigned& nx) {
    const unsigned G = gridDim.x * gridDim.y * gridDim.z;
    unsigned sum, cnt, mine, sp = 0u;
    for (;;) {
        sum = 0u; cnt = 0u; mine = 0u;
#pragma unroll
        for (unsigned j = 0; j < 16; ++j) { const unsigned c = xb_ld(&bar[XB_XCNT(j)]); sum += c; cnt += (c > 0u) ? 1u : 0u; mine = (j == x) ? c : mine; }
        if (sum == G) break;
        __builtin_amdgcn_s_sleep(1);
        if ((++sp & 255u) == 0u) { if (xb_ld(&bar[XB_TMO])) break; if (sp > XB_SPIN_CAP) { atomicAdd(&bar[XB_TMO], 1u); break; } }
    }
    nloc = mine > 0u ? mine : 1u; nx = cnt > 0u ? cnt : 1u;
}
__device__ __forceinline__ void xcd_barrier(const XcdBarrier& b) {
    asm volatile("s_waitcnt vmcnt(0)" ::: "memory");
    __syncthreads();
    if (threadIdx.x == 0) {
        unsigned* bar = b.bar;
        __builtin_amdgcn_s_waitcnt(0);
        unsigned nloc = b.st[0], nx = b.st[1];
        if (nloc == 0u) { xcd_barrier_complete(bar, b.x, nloc, nx); b.st[0] = nloc; b.st[1] = nx; }
        const unsigned old = xb_add(&bar[XB_XSUB(b.x)], 1u);
        const unsigned gen = old / nloc;
        if (old + 1u == (gen + 1u) * nloc) {
            __builtin_amdgcn_fence(__ATOMIC_RELEASE, "agent");
            asm volatile("s_waitcnt vmcnt(0)" ::: "memory");
            const unsigned og = xb_add(&bar[XB_TOP], 1u);
            const unsigned tg = og / nx;
            if (og + 1u == (tg + 1u) * nx) xb_add(&bar[XB_TOPGEN], 1u);
            else XB_SPIN(xb_ld(&bar[XB_TOPGEN]) == tg, bar);
            __builtin_amdgcn_fence(__ATOMIC_ACQUIRE, "agent");
            xb_add(&bar[XB_XGEN(b.x)], 1u);
            asm volatile("s_waitcnt vmcnt(0)" ::: "memory");
        } else {
            XB_SPIN(xb_ld(&bar[XB_XGEN(b.x)]) == gen, bar);
            __builtin_amdgcn_fence(__ATOMIC_ACQUIRE, "agent");
            asm volatile("s_waitcnt vmcnt(0)" ::: "memory");
        }
    }
    __syncthreads();
}

__device__ __forceinline__ void p0_transpose_item(const float* W, int ldw, int nblk, int K, bf16* WT, LAS float* scr, int item, int lane, int nscale) {
    const int kb = item / nblk, nb = item % nblk, k0 = 64 * kb, n0 = 32 * nb;
#pragma unroll 8
    for (int i = 0; i < 32; ++i) { const int kk = 2 * i + (lane >> 5); scr[kk * 33 + (lane & 31)] = W[(size_t)(k0 + kk) * ldw + n0 + (lane & 31)]; }
    LDS_WAIT(); asm volatile("" ::: "memory");
    const int c = lane & 7;
    const float sc = (n0 < nscale) ? 0.0625f : 1.f;
#pragma unroll
    for (int j = 0; j < 4; ++j) { const int n = (lane >> 3) + 8 * j; const LAS float* s = scr + (8 * c) * 33 + n;
        v4u o; o.x = pk2(s[0 * 33] * sc, s[1 * 33] * sc); o.y = pk2(s[2 * 33] * sc, s[3 * 33] * sc); o.z = pk2(s[4 * 33] * sc, s[5 * 33] * sc); o.w = pk2(s[6 * 33] * sc, s[7 * 33] * sc);
        *(GAS v4u*)(WT + (size_t)(n0 + n) * K + k0 + 8 * c) = o; }
    LDS_WAIT(); asm volatile("" ::: "memory");
}

struct Ptrs {
    const float *x, *norm_pre, *norm_post, *gla_w_in, *gla_w_gate2, *gla_b_gate, *gla_o_gain, *gla_w_out, *sgu_w_in, *sgu_ln_gain, *sgu_ln_bias, *sgu_w_spatial, *sgu_b_spatial, *sgu_w_out;
    float* out; unsigned char* ws;
};

__device__ __forceinline__ void phase_s0(const Ptrs& P, LAS unsigned char* lds, int vcu, int G, int tid, int lane, int wave) {
    unsigned char* ws = P.ws;
    LAS float* scr = (LAS float*)(lds + wave * 16384);
    const int gw = vcu * NWAVES + wave, NGW = G * NWAVES;
    constexpr int I1 = 32 * 192, I2 = 32 * 64, I3 = 32 * 192, I4 = 32 * 64, NITEMS = I1 + I2 + I3 + I4;
    for (int it = gw; it < NITEMS; it += NGW) {
        int r = it;
        if (r < I1) { p0_transpose_item(P.gla_w_in, GLA_IN, 192, DM, (bf16*)(ws + WS_WT1), scr, r, lane, GDK); continue; } r -= I1;
        if (r < I2) { p0_transpose_item(P.gla_w_out, DM, 64, GDV, (bf16*)(ws + WS_WT2), scr, r, lane, 0); continue; } r -= I2;
        if (r < I3) { p0_transpose_item(P.sgu_w_in, SGU_IN, 192, DM, (bf16*)(ws + WS_WT3), scr, r, lane, 0); continue; } r -= I3;
        p0_transpose_item(P.sgu_w_out, DM, 64, SGW, (bf16*)(ws + WS_WT4), scr, r, lane, 0);
    }
    { bf16* wsp = (bf16*)(ws + WS_WSP);
      for (int e = (vcu * NTHR + tid); e < SGG * SBLK * SBLK; e += G * NTHR) { const int i = (e >> 7) & 127, j = e & 127; const float w = P.sgu_w_spatial[e]; wsp[e] = (bf16)f2bf(((i >> 6) >= (j >> 6)) ? w : 0.f); } }
    __syncthreads();
    constexpr int GP = 2052;
    LAS float* wg = (LAS float*)lds;
    for (int idx = tid; idx < DM * GRANK; idx += NTHR) { const int k = idx >> 4, j = idx & 15; wg[j * GP + k] = P.gla_w_in[(size_t)k * GLA_IN + GLA_N + j]; }
    __syncthreads();
    bf16* HA = (bf16*)(ws + WS_HA); float* GLR = (float*)(ws + WS_GLR);
    for (int m = gw; m < MT; m += NGW) {
        const GAS f32x4* xr = (const GAS f32x4*)(P.x + (size_t)m * DM) + lane;
        f32x4 v[8]; float s = 0.f;
#pragma unroll
        for (int j = 0; j < 8; ++j) { v[j] = xr[64 * j]; s += (v[j].x * v[j].x + v[j].y * v[j].y) + (v[j].z * v[j].z + v[j].w * v[j].w); }
        const float rstd = 1.f / sqrtf(wave_sum(s) * (1.f / DM) + EPS);
        GAS v2u* o8 = (GAS v2u*)(HA + (size_t)m * DM) + lane;
#pragma unroll
        for (int j = 0; j < 8; ++j) { const f32x4 g = *((const GAS f32x4*)P.norm_pre + lane + 64 * j); v[j] = v[j] * rstd * g;
            v2u o; o.x = pk2(v[j].x, v[j].y); o.y = pk2(v[j].z, v[j].w); o8[64 * j] = o; }
        float mine = 0.f;
#pragma unroll 1
        for (int jj = 0; jj < GRANK; ++jj) { float a = 0.f;
#pragma unroll
            for (int j = 0; j < 8; ++j) { const f32x4 w = *(const LAS f32x4*)(wg + jj * GP + 4 * lane + 256 * j); a += (v[j].x * w.x + v[j].y * w.y) + (v[j].z * w.z + v[j].w * w.w); }
            a = wave_sum(a); if (lane == jj) mine = a; }
        if (lane < GRANK) GLR[(size_t)m * GRANK + lane] = mine;
    }
    __syncthreads();
}

template <class Epi>
__device__ __forceinline__ void naive_gemm(LAS unsigned char* lds, const bf16* A, const bf16* Bt, int M, int N, int K, int bid, int G, int tid, const Epi& E) {
    LAS float* As = (LAS float*)lds; LAS float* Bs = As + 16 * 132;
    const int ty = tid >> 5, tx = tid & 31, lr = tid >> 2, lk = (tid & 3) * 4;
    const int ntn = N / 128, ntiles = (M / 128) * ntn;
    for (int t = bid; t < ntiles; t += G) {
        const int tm = t / ntn, tn = t % ntn;
        float acc[8][4];
#pragma unroll
        for (int i = 0; i < 8; ++i)
#pragma unroll
            for (int j = 0; j < 4; ++j) acc[i][j] = 0.f;
        const bf16* ap = A + (size_t)(tm * 128 + lr) * K + lk; const bf16* bp = Bt + (size_t)(tn * 128 + lr) * K + lk;
        for (int k0 = 0; k0 < K; k0 += 16) {
            const v2u av = *(const GAS v2u*)(ap + k0), bv = *(const GAS v2u*)(bp + k0);
            __syncthreads();
            As[(lk + 0) * 132 + lr] = bflo(av.x); As[(lk + 1) * 132 + lr] = bfhi(av.x); As[(lk + 2) * 132 + lr] = bflo(av.y); As[(lk + 3) * 132 + lr] = bfhi(av.y);
            Bs[(lk + 0) * 132 + lr] = bflo(bv.x); Bs[(lk + 1) * 132 + lr] = bfhi(bv.x); Bs[(lk + 2) * 132 + lr] = bflo(bv.y); Bs[(lk + 3) * 132 + lr] = bfhi(bv.y);
            __syncthreads();
#pragma unroll 2
            for (int kk = 0; kk < 16; ++kk) {
                const f32x4 a0 = *(const LAS f32x4*)(As + kk * 132 + ty * 8), a1 = *(const LAS f32x4*)(As + kk * 132 + ty * 8 + 4), b = *(const LAS f32x4*)(Bs + kk * 132 + tx * 4);
                const float a[8] = {a0.x, a0.y, a0.z, a0.w, a1.x, a1.y, a1.z, a1.w}; const float bb[4] = {b.x, b.y, b.z, b.w};
#pragma unroll
                for (int i = 0; i < 8; ++i)
#pragma unroll
                    for (int j = 0; j < 4; ++j) acc[i][j] += a[i] * bb[j];
            }
        }
#pragma unroll
        for (int i = 0; i < 8; ++i)
#pragma unroll
            for (int j = 0; j < 4; ++j) E(tm * 128 + ty * 8 + i, tn * 128 + tx * 4 + j, acc[i][j]);
    }
    __syncthreads();
}
struct NEpiGlaIn { bf16* O; __device__ __forceinline__ void operator()(int r, int c, float v) const { O[(size_t)r * GLA_N + c] = (bf16)f2bf(c >= 4096 ? silu_f(v) : v); } };
struct NEpiSguIn { bf16* O; __device__ __forceinline__ void operator()(int r, int c, float v) const { O[(size_t)r * SGU_IN + c] = (bf16)f2bf(c >= 4096 ? silu_f(v) : gelu_tanh_f(v)); } };
struct NEpiF32 { float* O; int ldc; __device__ __forceinline__ void operator()(int r, int c, float v) const { O[(size_t)r * ldc + c] = v; } };

__device__ __forceinline__ float log_sigmoid_f(float z) { return fminf(z, 0.f) - log1pf(expf(-fabsf(z))); }
__device__ __forceinline__ void phase_kdec(const Ptrs& P, LAS unsigned char* lds, int bid, int G, int tid) {
    unsigned char* ws = P.ws; bf16* PROJ = (bf16*)(ws + WS_PROJ); const float* GLR = (const float*)(ws + WS_GLR); float* DEC = (float*)(ws + WS_DEC);
    LAS float* gl = (LAS float*)lds;
    LAS float* tot = gl + 64 * 16;
    const int cp = tid & 127, tg = tid >> 7;
    for (int u = bid; u < (MT / CHUNK) * GH; u += G) {
        const int bc = u >> 2, h = u & 3, row0 = bc * CHUNK;
        __syncthreads();
        if (tid < 256) *(LAS f32x4*)(gl + tid * 4) = *(const GAS f32x4*)(GLR + (size_t)row0 * GRANK + tid * 4);
        const int col = h * DKH + 2 * cp;
        float w0[GRANK], w1[GRANK];
#pragma unroll
        for (int j = 0; j < GRANK; ++j) { w0[j] = P.gla_w_gate2[j * GDK + col]; w1[j] = P.gla_w_gate2[j * GDK + col + 1]; }
        const float b0 = P.gla_b_gate[col], b1 = P.gla_b_gate[col + 1];
        __syncthreads();
        float c0[16], c1[16]; float r0 = 0.f, r1 = 0.f;
#pragma unroll
        for (int t = 0; t < 16; ++t) { const LAS float* gr = gl + (tg * 16 + t) * 16; float z0 = b0, z1 = b1;
#pragma unroll
            for (int j = 0; j < GRANK; ++j) { const float gv = gr[j]; z0 += gv * w0[j]; z1 += gv * w1[j]; }
            r0 += log_sigmoid_f(z0) * 0.0625f; r1 += log_sigmoid_f(z1) * 0.0625f; c0[t] = r0; c1[t] = r1; }
        tot[tg * 256 + 2 * cp] = r0; tot[tg * 256 + 2 * cp + 1] = r1;
        __syncthreads();
        float p0 = 0.f, p1 = 0.f, e0 = 0.f, e1 = 0.f;
#pragma unroll
        for (int g = 0; g < 4; ++g) { const float t0 = tot[g * 256 + 2 * cp], t1 = tot[g * 256 + 2 * cp + 1]; if (g < tg) { p0 += t0; p1 += t1; } e0 += t0; e1 += t1; }
#pragma unroll
        for (int t = 0; t < 16; ++t) { GAS unsigned* kp = (GAS unsigned*)(PROJ + (size_t)(row0 + tg * 16 + t) * GLA_N + GDK + col); const unsigned kv = *kp;
            *kp = pk2(bflo(kv) * expf(e0 - (p0 + c0[t])), bfhi(kv) * expf(e1 - (p1 + c1[t]))); }
        if (tg == 0) { DEC[(size_t)bc * GDK + col] = expf(e0); DEC[(size_t)bc * GDK + col + 1] = expf(e1); }
    }
    __syncthreads();
}

__device__ __forceinline__ void phase_scan_naive(const Ptrs& P, LAS unsigned char* lds, int bid, int G, int tid) {
    unsigned char* ws = P.ws; const bf16* PROJ = (const bf16*)(ws + WS_PROJ); const float* DEC = (const float*)(ws + WS_DEC); bf16* OB = (bf16*)(ws + WS_HA);
    LAS bf16* Kd = (LAS bf16*)lds;
    LAS bf16* Qc = Kd + 64 * 256;
    LAS float* Vc = (LAS float*)(lds + 65536);
    LAS float* Ss = Vc + 64 * 32;
    LAS float* dec = Ss + 256 * 36;
    for (int u = bid; u < 256; u += G) {
        const int bh = u >> 4, b = bh >> 2, h = bh & 3, sl = u & 15;
        const int dkq = tid >> 5, dv = tid & 31;
        float S[16];
#pragma unroll
        for (int r = 0; r < 16; ++r) S[r] = 0.f;
        for (int c = 0; c < NCH; ++c) {
            const int row0 = b * SEQ + c * CHUNK;
            __syncthreads();
#pragma unroll
            for (int i = 0; i < 4; ++i) { const int idx = tid + NTHR * i, row = idx >> 5, seg = idx & 31;
                *(LAS v4u*)(Kd + row * 256 + seg * 8) = *(const GAS v4u*)(PROJ + (size_t)(row0 + row) * GLA_N + GDK + h * DKH + seg * 8);
                *(LAS v4u*)(Qc + row * 256 + seg * 8) = *(const GAS v4u*)(PROJ + (size_t)(row0 + row) * GLA_N + h * DKH + seg * 8); }
            if (tid < 256) { const int row = tid >> 2, seg = tid & 3; const v4u w = *(const GAS v4u*)(PROJ + (size_t)(row0 + row) * GLA_N + 2 * GDK + h * DVH + sl * 32 + seg * 8);
                LAS float* d = Vc + row * 32 + seg * 8; d[0] = bflo(w.x); d[1] = bfhi(w.x); d[2] = bflo(w.y); d[3] = bfhi(w.y); d[4] = bflo(w.z); d[5] = bfhi(w.z); d[6] = bflo(w.w); d[7] = bfhi(w.w);
                dec[tid] = DEC[(size_t)(b * NCH + c) * GDK + h * DKH + tid]; }
            __syncthreads();
#pragma unroll
            for (int r = 0; r < 16; ++r) S[r] *= dec[dkq * 16 + r];
            for (int t = 0; t < CHUNK; ++t) { const float v = Vc[t * 32 + dv]; const v4u k0 = *(const LAS v4u*)(Kd + t * 256 + dkq * 16), k1 = *(const LAS v4u*)(Kd + t * 256 + dkq * 16 + 8);
                S[0] += bflo(k0.x) * v; S[1] += bfhi(k0.x) * v; S[2] += bflo(k0.y) * v; S[3] += bfhi(k0.y) * v; S[4] += bflo(k0.z) * v; S[5] += bfhi(k0.z) * v; S[6] += bflo(k0.w) * v; S[7] += bfhi(k0.w) * v;
                S[8] += bflo(k1.x) * v; S[9] += bfhi(k1.x) * v; S[10] += bflo(k1.y) * v; S[11] += bfhi(k1.y) * v; S[12] += bflo(k1.z) * v; S[13] += bfhi(k1.z) * v; S[14] += bflo(k1.w) * v; S[15] += bfhi(k1.w) * v; }
#pragma unroll
            for (int r = 0; r < 16; ++r) Ss[(dkq * 16 + r) * 36 + dv] = S[r];
            __syncthreads();
            { const int t = tid >> 3, dvq = tid & 7; f32x4 o = {0.f, 0.f, 0.f, 0.f};
              for (int d8 = 0; d8 < 32; ++d8) { const v4u q = *(const LAS v4u*)(Qc + t * 256 + d8 * 8); const LAS float* sp = Ss + (d8 * 8) * 36 + dvq * 4;
                  o += *(const LAS f32x4*)(sp + 0 * 36) * bflo(q.x); o += *(const LAS f32x4*)(sp + 1 * 36) * bfhi(q.x); o += *(const LAS f32x4*)(sp + 2 * 36) * bflo(q.y); o += *(const LAS f32x4*)(sp + 3 * 36) * bfhi(q.y);
                  o += *(const LAS f32x4*)(sp + 4 * 36) * bflo(q.z); o += *(const LAS f32x4*)(sp + 5 * 36) * bfhi(q.z); o += *(const LAS f32x4*)(sp + 6 * 36) * bflo(q.w); o += *(const LAS f32x4*)(sp + 7 * 36) * bfhi(q.w); }
              v2u w; w.x = pk2(o.x, o.y); w.y = pk2(o.z, o.w);
              *(GAS v2u*)(OB + (size_t)(row0 + t) * GDV + h * DVH + sl * 32 + dvq * 4) = w; }
        }
    }
    __syncthreads();
}

__device__ __forceinline__ void phase_onorm(const Ptrs& P, int vcu, int G, int lane, int wave) {
    unsigned char* ws = P.ws; bf16* OB = (bf16*)(ws + WS_HA); const bf16* PROJ = (const bf16*)(ws + WS_PROJ);
    const int gw = vcu * NWAVES + wave, NGW = G * NWAVES;
    for (int s = gw; s < MT * GH; s += NGW) {
        const int row = s >> 2, h = s & 3; GAS v4u* op = (GAS v4u*)(OB + (size_t)row * GDV + h * DVH) + lane;
        const v4u w = *op; const v4u g = *((const GAS v4u*)(PROJ + (size_t)row * GLA_N + 4096 + h * DVH) + lane);
        float o[8] = {bflo(w.x), bfhi(w.x), bflo(w.y), bfhi(w.y), bflo(w.z), bfhi(w.z), bflo(w.w), bfhi(w.w)};
        const float gg[8] = {bflo(g.x), bfhi(g.x), bflo(g.y), bfhi(g.y), bflo(g.z), bfhi(g.z), bflo(g.w), bfhi(g.w)};
        float ss = 0.f;
#pragma unroll
        for (int i = 0; i < 8; ++i) ss += o[i] * o[i];
        const float rstd = 1.f / sqrtf(wave_sum(ss) * (1.f / DVH) + EPS);
        const f32x4 g0 = *((const GAS f32x4*)(P.gla_o_gain + h * DVH) + 2 * lane), g1 = *((const GAS f32x4*)(P.gla_o_gain + h * DVH) + 2 * lane + 1);
        const float og[8] = {g0.x, g0.y, g0.z, g0.w, g1.x, g1.y, g1.z, g1.w};
#pragma unroll
        for (int i = 0; i < 8; ++i) o[i] = o[i] * rstd * og[i] * gg[i];
        v4u r; r.x = pk2(o[0], o[1]); r.y = pk2(o[2], o[3]); r.z = pk2(o[4], o[5]); r.w = pk2(o[6], o[7]); *op = r;
    }
}

template <bool WITH_H>
__device__ __forceinline__ void phase_rowpass(const float* y, const float* xin, float* xout, const float* gpost, const float* gpre, bf16* hn, int vcu, int G, int lane, int wave) {
    const int gw = vcu * NWAVES + wave, NGW = G * NWAVES;
    for (int m = gw; m < MT; m += NGW) {
        const GAS f32x4* yr = (const GAS f32x4*)(y + (size_t)m * DM) + lane; const GAS f32x4* xr = (const GAS f32x4*)(xin + (size_t)m * DM) + lane;
        f32x4 v[8]; float s = 0.f;
#pragma unroll
        for (int j = 0; j < 8; ++j) { v[j] = yr[64 * j]; s += (v[j].x * v[j].x + v[j].y * v[j].y) + (v[j].z * v[j].z + v[j].w * v[j].w); }
        const float rstd = 1.f / sqrtf(wave_sum(s) * (1.f / DM) + EPS);
        float s2 = 0.f; GAS f32x4* xo = (GAS f32x4*)(xout + (size_t)m * DM) + lane;
#pragma unroll
        for (int j = 0; j < 8; ++j) { const f32x4 g = *((const GAS f32x4*)gpost + lane + 64 * j); v[j] = xr[64 * j] + v[j] * rstd * g; xo[64 * j] = v[j];
            s2 += (v[j].x * v[j].x + v[j].y * v[j].y) + (v[j].z * v[j].z + v[j].w * v[j].w); }
        if (WITH_H) { const float rstd2 = 1.f / sqrtf(wave_sum(s2) * (1.f / DM) + EPS); GAS v2u* o8 = (GAS v2u*)(hn + (size_t)m * DM) + lane;
#pragma unroll
            for (int j = 0; j < 8; ++j) { const f32x4 g = *((const GAS f32x4*)gpre + lane + 64 * j); const f32x4 hv = v[j] * rstd2 * g; v2u o; o.x = pk2(hv.x, hv.y); o.y = pk2(hv.z, hv.w); o8[64 * j] = o; } }
    }
}

__device__ __forceinline__ void phase_sgu_naive(const Ptrs& P, LAS unsigned char* lds, int bid, int G, int tid, int lane, int wave) {
    unsigned char* ws = P.ws; const bf16* PROJ = (const bf16*)(ws + WS_PROJ); const bf16* WSP = (const bf16*)(ws + WS_WSP); bf16* A5 = (bf16*)(ws + WS_HA);
    LAS bf16* vn = (LAS bf16*)lds;
    LAS bf16* wl = vn + 128 * 256;
    LAS float* mu = (LAS float*)(lds + 65536 + 32768);
    LAS float* rs = mu + 128;
    for (int u = bid; u < 512; u += G) {
        const int bn = u >> 3, g = u & 7, r0 = bn * SBLK;
        __syncthreads();
        for (int rr = 0; rr < 16; ++rr) { const int r = wave * 16 + rr; const GAS v4u* vp = (const GAS v4u*)(PROJ + (size_t)(r0 + r) * SGU_IN + SGW) + lane; float s = 0.f, ss = 0.f;
#pragma unroll
            for (int i = 0; i < 4; ++i) { const v4u w = vp[64 * i]; const float e[8] = {bflo(w.x), bfhi(w.x), bflo(w.y), bfhi(w.y), bflo(w.z), bfhi(w.z), bflo(w.w), bfhi(w.w)};
#pragma unroll
                for (int k = 0; k < 8; ++k) { s += e[k]; ss += e[k] * e[k]; } }
            s = wave_sum(s); ss = wave_sum(ss); const float m = s * (1.f / SGW); const float var = ss * (1.f / SGW) - m * m;
            if (lane == 0) { mu[r] = m; rs[r] = 1.f / sqrtf(fmaxf(var, 0.f) + EPS); } }
        __syncthreads();
#pragma unroll
        for (int i = 0; i < 8; ++i) { const int idx = tid + NTHR * i, row = idx >> 5, seg = idx & 31; const int col = g * SGD + seg * 8;
            const v4u w = *(const GAS v4u*)(PROJ + (size_t)(r0 + row) * SGU_IN + SGW + col); const float m = mu[row], r = rs[row];
            const f32x4 ga = *(const GAS f32x4*)(P.sgu_ln_gain + col), gb = *(const GAS f32x4*)(P.sgu_ln_gain + col + 4), ba = *(const GAS f32x4*)(P.sgu_ln_bias + col), bb = *(const GAS f32x4*)(P.sgu_ln_bias + col + 4);
            v4u o; o.x = pk2((bflo(w.x) - m) * r * ga.x + ba.x, (bfhi(w.x) - m) * r * ga.y + ba.y); o.y = pk2((bflo(w.y) - m) * r * ga.z + ba.z, (bfhi(w.y) - m) * r * ga.w + ba.w);
            o.z = pk2((bflo(w.z) - m) * r * gb.x + bb.x, (bfhi(w.z) - m) * r * gb.y + bb.y); o.w = pk2((bflo(w.w) - m) * r * gb.z + bb.z, (bfhi(w.w) - m) * r * gb.w + bb.w);
            *(LAS v4u*)(vn + row * 256 + seg * 8) = o; }
#pragma unroll
        for (int i = 0; i < 4; ++i) { const int idx = tid + NTHR * i; *(LAS v4u*)(wl + idx * 8) = *(const GAS v4u*)(WSP + (size_t)g * SBLK * SBLK + idx * 8); }
        __syncthreads();
        const int d = tid & 255, ih = tid >> 8;
        for (int ib = 0; ib < 4; ++ib) { const int i0 = ih * 64 + ib * 16; float acc[16];
#pragma unroll
            for (int ii = 0; ii < 16; ++ii) acc[ii] = 0.f;
            for (int jb = 0; jb < 16; ++jb) { float v[8];
#pragma unroll
                for (int jj = 0; jj < 8; ++jj) v[jj] = bf2f(vn[(jb * 8 + jj) * 256 + d]);
#pragma unroll
                for (int ii = 0; ii < 16; ++ii) { const v4u w = *(const LAS v4u*)(wl + (i0 + ii) * 128 + jb * 8);
                    acc[ii] += bflo(w.x) * v[0] + bfhi(w.x) * v[1] + bflo(w.y) * v[2] + bfhi(w.y) * v[3] + bflo(w.z) * v[4] + bfhi(w.z) * v[5] + bflo(w.w) * v[6] + bfhi(w.w) * v[7]; } }
#pragma unroll
            for (int ii = 0; ii < 16; ++ii) { const int i = i0 + ii; const size_t tok = (size_t)(r0 + i); const int col = g * SGD + d;
                const float vs = acc[ii] + P.sgu_b_spatial[g * SBLK + i]; const float uu = bf2f(PROJ[tok * SGU_IN + col]), sg = bf2f(PROJ[tok * SGU_IN + 2 * SGW + col]);
                A5[tok * SGW + col] = (bf16)f2bf(uu * vs * sg); } }
    }
    __syncthreads();
}

struct Args { const float* in[14]; float* out; unsigned char* ws; };
__global__ void __launch_bounds__(NTHR, 2) mk_fwd(Args args) {
    extern __shared__ __attribute__((aligned(16))) unsigned char lds_raw[];
    LAS unsigned char* lds = (LAS unsigned char*)lds_raw;
    volatile LAS unsigned* MISC = (volatile LAS unsigned*)(lds + MISC_OFF);
    int tid = threadIdx.x, lane = tid & 63; const int wave = __builtin_amdgcn_readfirstlane(tid >> 6);
#define FRESH() do { tid = threadIdx.x; asm volatile("" : "+v"(tid)); lane = tid & 63; } while (0)
    const int G = gridDim.x, bx = blockIdx.x, vcu = (G % 8 == 0) ? (bx % 8) * (G / 8) + bx / 8 : bx;
    Ptrs P;
    P.x = args.in[0]; P.norm_pre = args.in[1]; P.norm_post = args.in[2]; P.gla_w_in = args.in[3]; P.gla_w_gate2 = args.in[4]; P.gla_b_gate = args.in[5]; P.gla_o_gain = args.in[6]; P.gla_w_out = args.in[7];
    P.sgu_w_in = args.in[8]; P.sgu_ln_gain = args.in[9]; P.sgu_ln_bias = args.in[10]; P.sgu_w_spatial = args.in[11]; P.sgu_b_spatial = args.in[12]; P.sgu_w_out = args.in[13]; P.out = args.out; P.ws = args.ws;
    unsigned char* ws = args.ws;
    gu32* ctl = (gu32*)(ws + WS_CTL);
    for (int u = tid; u < (LDS_BYTES - LDSCTL_OFF) / 4; u += NTHR) ((LAS unsigned*)(lds + LDSCTL_OFF))[u] = 0u;
    __syncthreads();
    XcdBarrier bar = xcd_barrier_post((unsigned*)(ctl + CW_BAR), MISC + 8);
#define GRID_BAR() do { xcd_barrier(bar); FRESH(); } while (0)

    phase_s0(P, lds, vcu, G, tid, lane, wave);
    GRID_BAR();
    { NEpiGlaIn E{(bf16*)(ws + WS_PROJ)}; naive_gemm(lds, (const bf16*)(ws + WS_HA), (const bf16*)(ws + WS_WT1), MT, GLA_N, DM, bx, G, tid, E); }
    GRID_BAR();
    phase_kdec(P, lds, bx, G, tid);
    GRID_BAR();
    phase_scan_naive(P, lds, bx, G, tid);
    GRID_BAR();
    phase_onorm(P, vcu, G, lane, wave);
    GRID_BAR();
    { NEpiF32 E{(float*)(ws + WS_PROJ), DM}; naive_gemm(lds, (const bf16*)(ws + WS_HA), (const bf16*)(ws + WS_WT2), MT, DM, GDV, bx, G, tid, E); }
    GRID_BAR();
    phase_rowpass<true>((const float*)(ws + WS_PROJ), P.x, P.out, P.norm_post, P.norm_pre + DM, (bf16*)(ws + WS_H1), vcu, G, lane, wave);
    GRID_BAR();
    { NEpiSguIn E{(bf16*)(ws + WS_PROJ)}; naive_gemm(lds, (const bf16*)(ws + WS_H1), (const bf16*)(ws + WS_WT3), MT, SGU_IN, DM, bx, G, tid, E); }
    GRID_BAR();
    phase_sgu_naive(P, lds, bx, G, tid, lane, wave);
    GRID_BAR();
    { NEpiF32 E{(float*)(ws + WS_PROJ), DM}; naive_gemm(lds, (const bf16*)(ws + WS_HA), (const bf16*)(ws + WS_WT4), MT, DM, SGW, bx, G, tid, E); }
    GRID_BAR();
    phase_rowpass<false>((const float*)(ws + WS_PROJ), P.out, P.out, P.norm_post + DM, nullptr, nullptr, vcu, G, lane, wave);
    if (__hip_atomic_load((gu32*)((unsigned*)(ctl + CW_BAR) + XB_TMO), RLX_AGENT) != 0u) { VM_WAIT(); __syncthreads(); const float q = __builtin_nanf("");
        for (size_t e = (size_t)bx * NTHR + tid; e < (size_t)MT * DM; e += (size_t)G * NTHR) P.out[e] = q; }
}

extern "C" void kernel_launch(void* const* d_in, const int* in_sizes, int n_in, void* d_out, int out_size, void* d_ws, size_t ws_size, hipStream_t stream) {
    static int grid = 0;
    if (grid == 0) {
        if (n_in != 14 || in_sizes[0] != MT * DM || out_size != MT * DM || ws_size < WS_END) { fprintf(stderr, "kernel_launch: unexpected shapes (n_in %d, in0 %d, out %d, ws %zu); nothing launched\n", n_in, n_in > 0 ? in_sizes[0] : -1, out_size, ws_size); grid = -1; return; }
        int dev = 0, cus = 0, per_cu = 0;
        if (hipGetDevice(&dev) != hipSuccess || hipDeviceGetAttribute(&cus, hipDeviceAttributeMultiprocessorCount, dev) != hipSuccess) { grid = -1; return; }
        if (hipFuncSetAttribute((const void*)mk_fwd, hipFuncAttributeMaxDynamicSharedMemorySize, LDS_BYTES) != hipSuccess) { fprintf(stderr, "kernel_launch: hipFuncSetAttribute failed\n"); grid = -1; return; }
        if (hipOccupancyMaxActiveBlocksPerMultiprocessor(&per_cu, (const void*)mk_fwd, NTHR, LDS_BYTES) != hipSuccess || per_cu < 1) { fprintf(stderr, "kernel_launch: occupancy query says %d blocks per CU\n", per_cu); per_cu = 1; }
        (void)hipGetLastError();
        grid = cus;
    }
    if (grid < 0) return;
    if (hipMemsetAsync((char*)d_ws + WS_CTL, 0, CTL_ZERO_BYTES, stream) != hipSuccess) { fprintf(stderr, "kernel_launch: memset failed\n"); return; }
    Args a{};
    for (int i = 0; i < 14; ++i) a.in[i] = (const float*)d_in[i];
    a.out = (float*)d_out; a.ws = (unsigned char*)d_ws;
    hipLaunchKernelGGL(mk_fwd, dim3(grid), dim3(NTHR), LDS_BYTES, stream, a);
}
```
